# Optimizing an MI355X kernel written in HIP

```python
import math
import jax, jax.numpy as jnp
from jax import lax
import numpy as np

D_MODEL = 1024
BATCH = 8
SEQ = 4096
DEPTH = 1

D_LRU = D_MODEL // 2
D_POOL = D_MODEL - D_LRU
D_MIX = D_LRU + D_POOL
LRU_HEADS = 8
LRU_HEAD_DIM = D_LRU // LRU_HEADS
CONV_WIDTH = 4
LRU_C = 8.0
POOL_WINDOWS = (2, 4, 8, 16)
POOL_GROUPS = len(POOL_WINDOWS)
POOL_GROUP_DIM = D_POOL // POOL_GROUPS
N_EXPERTS = 256
TOP_K = 8
N_EXPERT_GROUPS = 8
TOPK_GROUPS = 4
D_EXPERT = D_MODEL // 4
ROUTED_SCALE = 2.5
DISPATCH_BLOCK = 256
LN_EPS = 1e-5
DEEPNORM_ALPHA = (2.0 * DEPTH) ** 0.25
DEEPNORM_BETA = (8.0 * DEPTH) ** -0.25

kernel_name = "hybrid_rglru_pool_moe_deepnorm"


def layer_norm(x, g, b):
    xf = x.astype(jnp.float32)
    mu = xf.mean(-1, keepdims=True)
    var = jnp.square(xf - mu).mean(-1, keepdims=True)
    y = (xf - mu) * lax.rsqrt(var + LN_EPS) * g.astype(jnp.float32) + b.astype(jnp.float32)
    return y.astype(x.dtype)


def causal_depthwise_conv(u, w, b):
    y = lax.conv_general_dilated(
        u, w[:, None, :].astype(u.dtype), window_strides=(1,),
        padding=[(CONV_WIDTH - 1, 0)],
        dimension_numbers=("NWC", "WIO", "NWC"),
        feature_group_count=u.shape[-1])
    return y + b.astype(u.dtype)


def rg_lru(u, wa, ba, wx, bx, lam):
    B, S, C = u.shape
    uh = u.reshape(B, S, LRU_HEADS, LRU_HEAD_DIM)
    r = jax.nn.sigmoid((jnp.einsum("bshi,hij->bshj", uh, wa).reshape(B, S, C) + ba).astype(jnp.float32))
    i = jax.nn.sigmoid((jnp.einsum("bshi,hij->bshj", uh, wx).reshape(B, S, C) + bx).astype(jnp.float32))
    log_a = -LRU_C * r * jax.nn.softplus(-lam.astype(jnp.float32))
    a = jnp.exp(log_a)
    mult = jnp.sqrt(-jnp.expm1(2.0 * log_a))
    mult = mult.at[:, 0].set(1.0)
    xin = mult * i * u.astype(jnp.float32)

    def combine(left, right):
        a1, b1 = left
        a2, b2 = right
        return a1 * a2, a2 * b1 + b2

    _, h = lax.associative_scan(combine, (a, xin), axis=1)
    return h.astype(u.dtype)


def causal_multiscale_pool(v, pool_w, pool_scale):
    B, S, C = v.shape
    vf = v.astype(jnp.float32).reshape(B, S, POOL_GROUPS, POOL_GROUP_DIM)
    cs = jnp.concatenate([jnp.zeros((B, 1, POOL_GROUPS, POOL_GROUP_DIM), jnp.float32),
                          jnp.cumsum(vf, axis=1)], axis=1)
    t = jnp.arange(S, dtype=jnp.int32)[:, None]
    win = jnp.array(POOL_WINDOWS, dtype=jnp.int32)[None, :]
    lo = jnp.maximum(t + 1 - win, 0)
    gidx = jnp.arange(POOL_GROUPS, dtype=jnp.int32)[None, :]
    window_sum = cs[:, 1:] - cs[:, lo, gidx]
    count = (t + 1 - lo).astype(jnp.float32)
    pooled = (window_sum / count[None, :, :, None] - vf).astype(v.dtype)
    y = jnp.einsum("bsgi,gij->bsgj", pooled, pool_w).reshape(B, S, C)
    return y * pool_scale


def hybrid_mixer(x, w_in, conv_w, conv_b, lru_wa, lru_ba, lru_wx, lru_bx, lru_lambda, pool_w, pool_scale, w_out):
    proj = jnp.einsum("bsd,dc->bsc", x, w_in)
    u = proj[..., :D_LRU]
    gate = proj[..., D_LRU:2 * D_LRU]
    v = proj[..., 2 * D_LRU:]
    u = causal_depthwise_conv(u, conv_w, conv_b)
    y_lru = rg_lru(u, lru_wa, lru_ba, lru_wx, lru_bx, lru_lambda) * jax.nn.gelu(gate)
    y_pool = causal_multiscale_pool(v, pool_w, pool_scale)
    y = jnp.concatenate([y_lru, y_pool], axis=-1)
    return jnp.einsum("bsc,cd->bsd", y, w_out)


def moe_ffn(x2, router_w, router_bias, w1, w3, w2, sw1, sw3, sw2):
    T, D = x2.shape
    E = N_EXPERTS
    scores = jax.nn.sigmoid(jnp.dot(x2.astype(jnp.float32), router_w.astype(jnp.float32)))
    biased = scores + router_bias.astype(jnp.float32)
    grouped = biased.reshape(T, N_EXPERT_GROUPS, E // N_EXPERT_GROUPS)
    group_score = lax.top_k(grouped, 2)[0].sum(-1)
    _, top_groups = lax.top_k(group_score, TOPK_GROUPS)
    group_keep = (top_groups[:, :, None] == jnp.arange(N_EXPERT_GROUPS)[None, None, :]).any(1)
    masked = jnp.where(group_keep[:, :, None], grouped, -jnp.inf).reshape(T, E)
    _, idx = lax.top_k(masked, TOP_K)
    gate = jnp.take_along_axis(scores, idx, axis=-1)
    gate = gate / gate.sum(-1, keepdims=True) * ROUTED_SCALE

    A = T * TOP_K
    n_blocks = -(-A // DISPATCH_BLOCK) + E
    e_flat = idx.reshape(A).astype(jnp.int32)
    order = jnp.argsort(e_flat)
    e_sorted = e_flat[order]
    tok_sorted = (order // TOP_K).astype(jnp.int32)
    gate_sorted = gate.reshape(A)[order]
    counts = jnp.bincount(e_flat, length=E).astype(jnp.int32)
    padded = (counts + DISPATCH_BLOCK - 1) // DISPATCH_BLOCK * DISPATCH_BLOCK
    pad_end = jnp.cumsum(padded)
    pad_start = pad_end - padded
    grp_start = jnp.cumsum(counts) - counts
    dest = pad_start[e_sorted] + jnp.arange(A, dtype=jnp.int32) - grp_start[e_sorted]
    P = n_blocks * DISPATCH_BLOCK
    slot_tok = jnp.zeros((P,), jnp.int32).at[dest].set(tok_sorted)
    slot_gate = jnp.zeros((P,), jnp.float32).at[dest].set(gate_sorted)
    block_start = jnp.arange(n_blocks, dtype=jnp.int32) * DISPATCH_BLOCK
    block_expert = jnp.minimum(jnp.searchsorted(pad_end, block_start, side="right"), E - 1)

    def expert_block(acc, blk):
        tok, g, e = blk
        xb = x2[tok]
        hb = jax.nn.silu(xb @ w1[e]) * (xb @ w3[e])
        yb = (hb @ w2[e]).astype(jnp.float32) * g[:, None]
        return acc.at[tok].add(yb), None

    routed, _ = lax.scan(expert_block, jnp.zeros((T, D), jnp.float32),
                         (slot_tok.reshape(n_blocks, DISPATCH_BLOCK),
                          slot_gate.reshape(n_blocks, DISPATCH_BLOCK),
                          block_expert))
    shared = (jax.nn.silu(x2 @ sw1) * (x2 @ sw3)) @ sw2
    return (routed + shared.astype(jnp.float32)).astype(x2.dtype)


def setup_inputs(seed: int = 0) -> dict:
    key = jax.random.key(seed)
    ks = jax.random.split(key, 24)
    L = DEPTH
    f32 = jnp.float32

    def nrm(k, shape, scale):
        return jax.random.normal(k, shape, f32) * scale

    u = jax.random.uniform(ks[9], (L, D_LRU), f32, minval=0.9, maxval=0.999)
    s = u ** (1.0 / LRU_C)
    lru_lambda = jnp.log(s) - jnp.log1p(-s)
    return {
        "x": nrm(ks[0], (BATCH, SEQ, D_MODEL), 1.0),
        "w_in": nrm(ks[1], (L, D_MODEL, 2 * D_LRU + D_POOL), D_MODEL ** -0.5),
        "conv_w": nrm(ks[2], (L, CONV_WIDTH, D_LRU), CONV_WIDTH ** -0.5),
        "conv_b": nrm(ks[3], (L, D_LRU), 0.02),
        "lru_wa": nrm(ks[4], (L, LRU_HEADS, LRU_HEAD_DIM, LRU_HEAD_DIM), LRU_HEAD_DIM ** -0.5),
        "lru_ba": nrm(ks[5], (L, D_LRU), 0.02),
        "lru_wx": nrm(ks[6], (L, LRU_HEADS, LRU_HEAD_DIM, LRU_HEAD_DIM), LRU_HEAD_DIM ** -0.5),
        "lru_bx": nrm(ks[7], (L, D_LRU), 0.02),
        "lru_lambda": lru_lambda,
        "pool_w": nrm(ks[10], (L, POOL_GROUPS, POOL_GROUP_DIM, POOL_GROUP_DIM), POOL_GROUP_DIM ** -0.5),
        "pool_scale": 1.0 + nrm(ks[11], (L, D_POOL), 0.02),
        "w_out": nrm(ks[12], (L, D_MIX, D_MODEL), DEEPNORM_BETA * D_MIX ** -0.5),
        "ln1_g": 1.0 + nrm(ks[13], (L, D_MODEL), 0.02),
        "ln1_b": nrm(ks[14], (L, D_MODEL), 0.02),
        "router_w": nrm(ks[15], (L, D_MODEL, N_EXPERTS), D_MODEL ** -0.5),
        "router_bias": nrm(ks[16], (L, N_EXPERTS), 0.01),
        "exp_w1": nrm(ks[17], (L, N_EXPERTS, D_MODEL, D_EXPERT), D_MODEL ** -0.5),
        "exp_w3": nrm(ks[18], (L, N_EXPERTS, D_MODEL, D_EXPERT), D_MODEL ** -0.5),
        "exp_w2": nrm(ks[19], (L, N_EXPERTS, D_EXPERT, D_MODEL), DEEPNORM_BETA * D_EXPERT ** -0.5),
        "sh_w1": nrm(ks[20], (L, D_MODEL, D_EXPERT), D_MODEL ** -0.5),
        "sh_w3": nrm(ks[21], (L, D_MODEL, D_EXPERT), D_MODEL ** -0.5),
        "sh_w2": nrm(ks[22], (L, D_EXPERT, D_MODEL), DEEPNORM_BETA * D_EXPERT ** -0.5),
        "ln2_g": 1.0 + nrm(ks[23], (L, D_MODEL), 0.02),
        "ln2_b": nrm(ks[8], (L, D_MODEL), 0.02),
    }


def reference(x, w_in, conv_w, conv_b, lru_wa, lru_ba, lru_wx, lru_bx, lru_lambda, pool_w, pool_scale, w_out,
              ln1_g, ln1_b, router_w, router_bias, exp_w1, exp_w3, exp_w2, sh_w1, sh_w3, sh_w2, ln2_g, ln2_b):
    B, S, D = x.shape
    for l in range(DEPTH):
        mix = hybrid_mixer(x, w_in[l], conv_w[l], conv_b[l], lru_wa[l], lru_ba[l], lru_wx[l], lru_bx[l],
                           lru_lambda[l], pool_w[l], pool_scale[l], w_out[l])
        x = layer_norm(DEEPNORM_ALPHA * x + mix, ln1_g[l], ln1_b[l])
        ffn = moe_ffn(x.reshape(B * S, D), router_w[l], router_bias[l], exp_w1[l], exp_w3[l], exp_w2[l],
                      sh_w1[l], sh_w3[l], sh_w2[l]).reshape(B, S, D)
        x = layer_norm(DEEPNORM_ALPHA * x + ffn, ln2_g[l], ln2_b[l])
    return x
```

```cpp
#include <hip/hip_runtime.h>
#include <cstdio>

#define LAS __attribute__((address_space(3)))
#define GAS __attribute__((address_space(1)))
typedef unsigned short bf16_t;
typedef short bf16x8 __attribute__((ext_vector_type(8)));
typedef float f32x4 __attribute__((ext_vector_type(4)));
typedef float f32x2 __attribute__((ext_vector_type(2)));
typedef unsigned u32x4 __attribute__((ext_vector_type(4)));
typedef unsigned u32x2 __attribute__((ext_vector_type(2)));
typedef int i32x4 __attribute__((ext_vector_type(4)));
typedef __bf16 bfv2 __attribute__((ext_vector_type(2)));

#ifndef MK_N_LAUNCHES
#define MK_N_LAUNCHES 13
#endif

constexpr int BATCH = 8, SEQ = 4096, T = BATCH * SEQ, D = 1024, DL = 512, NPROJ = 1536, NE = 256, DE = 256, TOPK = 8, NASSIGN = T * TOPK;
constexpr int NHEAD = 8, HD = 64, PG = 4, PGD = 128;
constexpr float LN_EPS = 1e-5f, ALPHA = 1.189207115002721f  , ROUTED_SCALE = 2.5f, LOG2E = 1.4426950408889634f;
constexpr int NWAVES = 8, NT = NWAVES * 64;
constexpr int TT = 128;
constexpr int NPH = 13;
constexpr int N_LAUNCHES = MK_N_LAUNCHES;

constexpr size_t MiB = 1u << 20, KiB = 1024;
constexpr size_t WS_CTL = 0, CTL_ZERO_BYTES = 256 * KiB;
constexpr size_t WS_GW = 1 * MiB;
constexpr size_t WS_PW = 1 * MiB + 128 * KiB;
constexpr size_t WS_AGG = 1 * MiB + 256 * KiB;
constexpr size_t WS_CNT = 2 * MiB + 512 * KiB;
constexpr size_t WS_TILE = 2 * MiB + 768 * KiB;
constexpr size_t WS_WIN = 3 * MiB;
constexpr size_t WS_WOUT = 6 * MiB;
constexpr size_t WS_WRS = 8 * MiB;
constexpr size_t WS_WS2 = 9 * MiB + 512 * KiB;
constexpr size_t WS_EW2 = 10 * MiB;
constexpr size_t WS_X1 = 138 * MiB;
constexpr size_t WS_LOGIT = 202 * MiB;
constexpr size_t WS_HS = 234 * MiB;
constexpr size_t WS_IDX = 250 * MiB, WS_GATEV = 251 * MiB, WS_POS = 252 * MiB, WS_STOK = 253 * MiB, WS_SGATE = 254 * MiB;
constexpr size_t WS_HE = 256 * MiB;
constexpr size_t WS_EW13 = 384 * MiB;
constexpr size_t WS_XB = 640 * MiB;
constexpr size_t WS_PROJ = 704 * MiB;
constexpr size_t WS_Y = 800 * MiB;
constexpr size_t WS_Z1 = 640 * MiB;
constexpr size_t WS_YS = 384 * MiB;
constexpr size_t WS_END = 896 * MiB;
constexpr int CW_BAR = 1024;

constexpr int RING_BYTES = 131072;
constexpr int MISC_OFF = RING_BYTES + 320;
constexpr int UT_OFF = RING_BYTES + 1024;
constexpr int ROWS_OFF = RING_BYTES + 2048;
constexpr int LDS_BYTES = 160 * 1024;

#define RLX_AGENT __ATOMIC_RELAXED, __HIP_MEMORY_SCOPE_AGENT
__device__ __forceinline__ unsigned pk_bf16(float lo, float hi) { f32x2 v = {lo, hi}; bfv2 b = __builtin_convertvector(v, bfv2); return __builtin_bit_cast(unsigned, b); }
__device__ __forceinline__ float bf_lo(unsigned w) { return __uint_as_float(w << 16); }
__device__ __forceinline__ float bf_hi(unsigned w) { return __uint_as_float(w & 0xffff0000u); }
__device__ __forceinline__ float bf_get(const u32x4& w, int j) { const unsigned x = w[j >> 1]; return (j & 1) ? bf_hi(x) : bf_lo(x); }
__device__ __forceinline__ float fast_sigmoid(float x) { return __builtin_amdgcn_rcpf(1.0f + __builtin_amdgcn_exp2f(-LOG2E * x)); }
__device__ __forceinline__ float silu_f(float x) { return x * fast_sigmoid(x); }
__device__ __forceinline__ float gelu_tanh(float x) { const float u = 1.5957691216057308f * (x + 0.044715f * x * x * x); return x * fast_sigmoid(u); }
template <int CTRL> __device__ __forceinline__ float dppf(float old, float src) { return __builtin_bit_cast(float, __builtin_amdgcn_update_dpp(__builtin_bit_cast(int, old), __builtin_bit_cast(int, src), CTRL, 0xF, 0xF, false)); }
__device__ __forceinline__ float wave_sum(float v) {
#pragma unroll
    for (int o = 1; o < 64; o <<= 1) v += __shfl_xor(v, o);
    return v;
}
__device__ __forceinline__ int ld_agent_i(const int* p) { return __builtin_amdgcn_readfirstlane(__hip_atomic_load(p, RLX_AGENT)); }

namespace pg8 {
constexpr int BM = 256, BK = 64, HALF = 128, HTB = HALF * BK * 2, STAGE_BYTES = 8 * HTB, NXCD = 8, WGM = 8;
__host__ __device__ __forceinline__ int lds_byte(int r, int c) { const int st = (r >> 4) * 2 + (c >> 5), rr = r & 15, cc = c & 31, ob = rr * 64 + cc * 2; return st * 1024 + (ob ^ (((ob >> 9) & 1) << 5)); }
__host__ __device__ __forceinline__ void stage_rc(int b, int& R, int& C) { const int st = b / 1024, sb = b % 1024, swz = sb ^ (((sb >> 9) & 1) << 5); R = (st >> 1) * 16 + swz / 64; C = (st & 1) * 32 + (swz % 64) / 2; }
__host__ __device__ __forceinline__ int perm32(int rho) { const int n = rho >> 4, i = rho & 15; return 8 * (i >> 2) + 4 * n + (i & 3); }

struct Unit { int a0, nrows, b0, aux; };

struct DenseOrder {
    int nM, nN, nwg, G, c;
    __device__ void init(int M, int N, int G_, int c_) { nM = M / BM; nN = N / BM; nwg = nM * nN; G = G_; c = c_; }
    __device__ __forceinline__ bool next(int i, Unit& u) const {
        const long L = (long)i * G + c; if (L >= nwg) return false;
        int wgid = (int)L; { const int q = nwg / NXCD, r = nwg % NXCD, xcd = wgid % NXCD, off = wgid / NXCD; wgid = (xcd < r ? xcd * (q + 1) : r * (q + 1) + (xcd - r) * q) + off; }
        const int nig = WGM * nN, gid = wgid / nig, fm = gid * WGM, gsz = (nM - fm) < WGM ? (nM - fm) : WGM;
        const int pm = fm + ((wgid % nig) % gsz), pn = (wgid % nig) / gsz;
        u.a0 = pm * BM; u.nrows = BM; u.b0 = pn * BM; u.aux = pn; return true;
    }
    __device__ __forceinline__ int arow(int, int) const { return 0; }
};
struct GroupOrder {
    const LAS i32x4* UT; const LAS unsigned short* ROWS; int n;
    __device__ __forceinline__ bool next(int i, Unit& u) const { if (i >= n) return false; const i32x4 e = UT[i]; u.a0 = e.x; u.nrows = e.y; u.b0 = e.z; u.aux = e.w; return true; }
    __device__ __forceinline__ int arow(int i, int r) const { return (int)ROWS[i * 256 + r]; }
};

template <class Epi, class Sched, bool GATHER, bool ALIGN_EPI>
__device__ __forceinline__ void gemm_phase(LAS unsigned char* lds, const bf16_t* A, const bf16_t* Bt, const int K, const Sched& S, const Epi& E) {
    const int tid = threadIdx.x, wid = __builtin_amdgcn_readfirstlane(tid >> 6), lane = tid & 63, wr = wid >> 2, wc = wid & 3, fr = lane & 15, fq = lane >> 4;
    const int nt = K / BK;
    int Rr[2], Cc[2];
    unsigned voffA[2], voffB[2];
#pragma unroll
    for (int i = 0; i < 2; ++i) { int R, C; stage_rc(tid * 16 + i * 8192, R, C); Rr[i] = R; Cc[i] = C; const int Rb = Epi::PERM ? ((R & ~31) + perm32(R & 31)) : R;
        voffA[i] = (unsigned)(R * K + C) * 2u; voffB[i] = (unsigned)(Rb * K + C) * 2u; }
    const size_t kstep = (size_t)(BK * 2);
    const size_t hstep = (size_t)HALF * K * 2;
    const unsigned ldsw = (unsigned)wid * 1024u;
    const int aoff = lds_byte(wr * 64 + fr, fq * 8), boff = lds_byte(wc * 32 + fr, fq * 8);
#define PG8_SA(b, h) (((b) * 2 + (h)) * HTB)
#define PG8_SB(b, h) ((4 + (b) * 2 + (h)) * HTB)
#define PG8_STAGE(bufoff, gbase, voff) do { _Pragma("unroll") for (int _i = 0; _i < 2; ++_i) \
        __builtin_amdgcn_global_load_lds((const unsigned*)((const char*)(gbase) + (voff)[_i]), (LAS unsigned*)(lds + (bufoff) + ldsw + _i * 8192), 16, 0, 0); } while (0)
#define PG8_STAGE_A(bufoff, dbase, kb, off) do { if constexpr (GATHER) { PG8_STAGE(bufoff, (const char*)A + (kb), off); } else { PG8_STAGE(bufoff, dbase, voffA); } } while (0)
#define PG8_LDA(dst, b, h) do { _Pragma("unroll") for (int m = 0; m < 4; ++m) _Pragma("unroll") for (int k = 0; k < 2; ++k) dst[m][k] = *(const LAS bf16x8*)(lds + PG8_SA(b, h) + aoff + m * 2048 + k * 1024); } while (0)
#define PG8_LDB(dst, b, h) do { _Pragma("unroll") for (int n = 0; n < 2; ++n) _Pragma("unroll") for (int k = 0; k < 2; ++k) dst[n][k] = *(const LAS bf16x8*)(lds + PG8_SB(b, h) + boff + n * 2048 + k * 1024); } while (0)
#define PG8_MMA(ai, bj, At, Bt_) do { __builtin_amdgcn_s_setprio(1); _Pragma("unroll") for (int m = 0; m < 4; ++m) _Pragma("unroll") for (int n = 0; n < 2; ++n) _Pragma("unroll") for (int k = 0; k < 2; ++k) \
        acc[ai][bj][m][n] = __builtin_amdgcn_mfma_f32_16x16x32_bf16(Bt_[n][k], At[m][k], acc[ai][bj][m][n], 0, 0, 0); __builtin_amdgcn_s_setprio(0); } while (0)
#define PG8_WAIT_V(n) asm volatile("s_waitcnt vmcnt(" #n ")" ::: "memory")
#define PG8_WAIT_L(n) asm volatile("s_waitcnt lgkmcnt(" #n ")" ::: "memory")
#define PG8_BAR __builtin_amdgcn_s_barrier()
#define PG8_SCHED __builtin_amdgcn_sched_barrier(0)
    Unit cur, nxt; int ui = 0;
    if (!S.next(0, cur)) return;
    f32x4 acc[2][2][4][2];
#pragma unroll
    for (int a = 0; a < 2; ++a)
#pragma unroll
        for (int b = 0; b < 2; ++b)
#pragma unroll
            for (int m = 0; m < 4; ++m)
#pragma unroll
                for (int n = 0; n < 2; ++n) acc[a][b][m][n] = (f32x4){0.f, 0.f, 0.f, 0.f};
    bf16x8 At[4][2], B0[2][2], B1[2][2];
    unsigned cv0[2] = {0u, 0u}, cv1[2] = {0u, 0u}, nv0[2] = {0u, 0u}, nv1[2] = {0u, 0u};
    if constexpr (GATHER) {
#pragma unroll
        for (int i = 0; i < 2; ++i) { cv0[i] = (unsigned)(S.arow(0, Rr[i]) * K + Cc[i]) * 2u; cv1[i] = (unsigned)(S.arow(0, HALF + Rr[i]) * K + Cc[i]) * 2u; }
    }
    const char* cA = (const char*)A + (size_t)cur.a0 * K * 2; const char* cB = (const char*)Bt + (size_t)cur.b0 * K * 2;
    PG8_STAGE(PG8_SB(0, 0), cB, voffB); PG8_STAGE(PG8_SB(0, 1), cB + hstep, voffB); PG8_STAGE_A(PG8_SA(0, 0), cA, 0, cv0); PG8_STAGE_A(PG8_SA(0, 1), cA + hstep, 0, cv1);
    if (wr == 1) PG8_BAR;
    PG8_WAIT_V(2); PG8_BAR;
    PG8_STAGE(PG8_SB(1, 0), cB + kstep, voffB); PG8_STAGE_A(PG8_SA(1, 0), cA + kstep, kstep, cv0); PG8_STAGE(PG8_SB(1, 1), cB + hstep + kstep, voffB);
    PG8_WAIT_V(6); PG8_BAR;
    for (;;) {
        const bool has_next = S.next(ui + 1, nxt);
        const char* nA = has_next ? (const char*)A + (size_t)nxt.a0 * K * 2 : cA; const char* nB = has_next ? (const char*)Bt + (size_t)nxt.b0 * K * 2 : cB;
#pragma nounroll
        for (int t = 0; t < nt; t += 2) {
            const bool last = (t == nt - 2);
            const char* a1 = cA + (size_t)(t + 1) * kstep;
            const char* a2 = last ? nA : cA + (size_t)(t + 2) * kstep; const char* b2 = last ? nB : cB + (size_t)(t + 2) * kstep;
            const char* a3 = a2 + kstep; const char* b3 = b2 + kstep;
            const size_t k1 = (size_t)(t + 1) * kstep, k2 = last ? 0 : (size_t)(t + 2) * kstep, k3 = k2 + kstep;
            unsigned s0[2], s1[2];
            if constexpr (GATHER) {
                if (last && has_next) {
#pragma unroll
                    for (int i = 0; i < 2; ++i) { nv0[i] = (unsigned)(S.arow(ui + 1, Rr[i]) * K + Cc[i]) * 2u; nv1[i] = (unsigned)(S.arow(ui + 1, HALF + Rr[i]) * K + Cc[i]) * 2u; }
                } else if (last) { nv0[0] = cv0[0]; nv0[1] = cv0[1]; nv1[0] = cv1[0]; nv1[1] = cv1[1]; }
#pragma unroll
                for (int i = 0; i < 2; ++i) { s0[i] = last ? nv0[i] : cv0[i]; s1[i] = last ? nv1[i] : cv1[i]; }
            } else { s0[0] = s0[1] = s1[0] = s1[1] = 0u; }
            PG8_LDB(B0, 0, 0); PG8_LDB(B1, 0, 1); PG8_SCHED; PG8_LDA(At, 0, 0); PG8_STAGE_A(PG8_SA(1, 1), a1 + hstep, k1, cv1);
            PG8_WAIT_V(8); PG8_WAIT_L(0); PG8_BAR; PG8_MMA(0, 0, At, B0); PG8_MMA(0, 1, At, B1); PG8_BAR; PG8_SCHED;
            PG8_LDA(At, 0, 1); PG8_STAGE(PG8_SB(0, 0), b2, voffB); PG8_STAGE(PG8_SB(0, 1), b2 + hstep, voffB); PG8_STAGE_A(PG8_SA(0, 0), a2, k2, s0);
            PG8_WAIT_V(8); PG8_WAIT_L(0); PG8_BAR; PG8_MMA(1, 0, At, B0); PG8_MMA(1, 1, At, B1); PG8_BAR; PG8_SCHED;
            PG8_LDB(B0, 1, 0); PG8_LDB(B1, 1, 1); PG8_SCHED; PG8_LDA(At, 1, 0); PG8_STAGE_A(PG8_SA(0, 1), a2 + hstep, k2, s1);
            PG8_WAIT_V(8); PG8_WAIT_L(0); PG8_BAR; PG8_MMA(0, 0, At, B0); PG8_MMA(0, 1, At, B1); PG8_BAR; PG8_SCHED;
            PG8_LDA(At, 1, 1); PG8_STAGE(PG8_SB(1, 0), b3, voffB); PG8_STAGE(PG8_SB(1, 1), b3 + hstep, voffB); PG8_STAGE_A(PG8_SA(1, 0), a3, k3, s0);
            PG8_WAIT_V(8); PG8_WAIT_L(0); PG8_BAR; PG8_MMA(1, 0, At, B0); PG8_MMA(1, 1, At, B1); PG8_BAR; PG8_SCHED;
        }
        if constexpr (ALIGN_EPI) { if (wr == 0) PG8_BAR; }
        E(acc, cur, wr, wc, fr, fq);
        if (!has_next) break;
#pragma unroll
        for (int a = 0; a < 2; ++a)
#pragma unroll
            for (int b = 0; b < 2; ++b)
#pragma unroll
                for (int m = 0; m < 4; ++m)
#pragma unroll
                    for (int n = 0; n < 2; ++n) acc[a][b][m][n] = (f32x4){0.f, 0.f, 0.f, 0.f};
        cur = nxt; cA = nA; cB = nB; ++ui;
        if constexpr (GATHER) { cv0[0] = nv0[0]; cv0[1] = nv0[1]; cv1[0] = nv1[0]; cv1[1] = nv1[1]; }
        if constexpr (ALIGN_EPI) { if (wr == 1) PG8_BAR; }
    }
    PG8_WAIT_V(0);
    if constexpr (!ALIGN_EPI) { if (wr == 0) PG8_BAR; }
    PG8_BAR;
#undef PG8_SA
#undef PG8_SB
#undef PG8_STAGE
#undef PG8_STAGE_A
#undef PG8_LDA
#undef PG8_LDB
#undef PG8_MMA
#undef PG8_WAIT_V
#undef PG8_WAIT_L
#undef PG8_BAR
#undef PG8_SCHED
}

struct EpiProj {
    static constexpr bool PERM = true;
    bf16_t* O;
    __device__ __forceinline__ void operator()(const f32x4 (&acc)[2][2][4][2], const Unit& u, int wr, int wc, int fr, int fq) const {
#pragma unroll
        for (int ai = 0; ai < 2; ++ai)
#pragma unroll
            for (int m = 0; m < 4; ++m) { bf16_t* rowp = O + (size_t)(u.a0 + ai * HALF + wr * 64 + m * 16 + fr) * NPROJ + u.b0 + wc * 32 + 8 * fq;
#pragma unroll
                for (int bj = 0; bj < 2; ++bj) { const f32x4 v0 = acc[ai][bj][m][0], v1 = acc[ai][bj][m][1];
                    u32x4 w; w.x = pk_bf16(v0[0], v0[1]); w.y = pk_bf16(v0[2], v0[3]); w.z = pk_bf16(v1[0], v1[1]); w.w = pk_bf16(v1[2], v1[3]);
                    *(u32x4*)(rowp + bj * HALF) = w; } }
    }
};
struct EpiMix {
    static constexpr bool PERM = false;
    const float* X; float* Z;
    __device__ __forceinline__ void operator()(const f32x4 (&acc)[2][2][4][2], const Unit& u, int wr, int wc, int fr, int fq) const {
#pragma unroll
        for (int ai = 0; ai < 2; ++ai)
#pragma unroll
            for (int m = 0; m < 4; ++m) { const size_t off = (size_t)(u.a0 + ai * HALF + wr * 64 + m * 16 + fr) * D + u.b0 + wc * 32 + 4 * fq;
#pragma unroll
                for (int bj = 0; bj < 2; ++bj)
#pragma unroll
                    for (int n = 0; n < 2; ++n) { const f32x4 xv = *(const f32x4*)(X + off + bj * HALF + n * 16); *(f32x4*)(Z + off + bj * HALF + n * 16) = xv * ALPHA + acc[ai][bj][m][n]; } }
    }
};
struct EpiRS {
    static constexpr bool PERM = false;
    float* LOGIT; bf16_t* HS;
    __device__ __forceinline__ void operator()(const f32x4 (&acc)[2][2][4][2], const Unit& u, int wr, int wc, int fr, int fq) const {
        if (u.aux == 0) {
#pragma unroll
            for (int ai = 0; ai < 2; ++ai)
#pragma unroll
                for (int m = 0; m < 4; ++m) { float* rowp = LOGIT + (size_t)(u.a0 + ai * HALF + wr * 64 + m * 16 + fr) * NE + wc * 32 + 4 * fq;
#pragma unroll
                    for (int bj = 0; bj < 2; ++bj)
#pragma unroll
                        for (int n = 0; n < 2; ++n) *(f32x4*)(rowp + bj * HALF + n * 16) = acc[ai][bj][m][n]; }
        } else {
#pragma unroll
            for (int ai = 0; ai < 2; ++ai)
#pragma unroll
                for (int m = 0; m < 4; ++m) { bf16_t* rowp = HS + (size_t)(u.a0 + ai * HALF + wr * 64 + m * 16 + fr) * DE + (u.aux - 1) * 128 + wc * 32 + 4 * fq;
#pragma unroll
                    for (int n = 0; n < 2; ++n) { const f32x4 a = acc[ai][0][m][n], b = acc[ai][1][m][n];
                        u32x2 w; w.x = pk_bf16(silu_f(a[0]) * b[0], silu_f(a[1]) * b[1]); w.y = pk_bf16(silu_f(a[2]) * b[2], silu_f(a[3]) * b[3]);
                        *(u32x2*)(rowp + n * 16) = w; } }
        }
    }
};
struct EpiUp {
    static constexpr bool PERM = true;
    bf16_t* HE;
    __device__ __forceinline__ void operator()(const f32x4 (&acc)[2][2][4][2], const Unit& u, int wr, int wc, int fr, int fq) const {
#pragma unroll
        for (int ai = 0; ai < 2; ++ai)
#pragma unroll
            for (int m = 0; m < 4; ++m) { const int r = ai * HALF + wr * 64 + m * 16 + fr;
                const f32x4 a0 = acc[ai][0][m][0], a1 = acc[ai][0][m][1], b0 = acc[ai][1][m][0], b1 = acc[ai][1][m][1];
                u32x4 w; w.x = pk_bf16(silu_f(a0[0]) * b0[0], silu_f(a0[1]) * b0[1]); w.y = pk_bf16(silu_f(a0[2]) * b0[2], silu_f(a0[3]) * b0[3]);
                w.z = pk_bf16(silu_f(a1[0]) * b1[0], silu_f(a1[1]) * b1[1]); w.w = pk_bf16(silu_f(a1[2]) * b1[2], silu_f(a1[3]) * b1[3]);
                if (r < u.nrows) *(u32x4*)(HE + (size_t)(u.a0 + r) * DE + u.aux * 128 + wc * 32 + 8 * fq) = w; }
    }
};
struct EpiDown {
    static constexpr bool PERM = true;
    bf16_t* YS; const float* SGATE;
    __device__ __forceinline__ void operator()(const f32x4 (&acc)[2][2][4][2], const Unit& u, int wr, int wc, int fr, int fq) const {
#pragma unroll
        for (int ai = 0; ai < 2; ++ai)
#pragma unroll
            for (int m = 0; m < 4; ++m) { const int r = ai * HALF + wr * 64 + m * 16 + fr;
                if (r < u.nrows) { const float g = SGATE[u.a0 + r]; bf16_t* rowp = YS + (size_t)(u.a0 + r) * D + u.aux * 256 + wc * 32 + 8 * fq;
#pragma unroll
                    for (int bj = 0; bj < 2; ++bj) { const f32x4 v0 = acc[ai][bj][m][0] * g, v1 = acc[ai][bj][m][1] * g;
                        u32x4 w; w.x = pk_bf16(v0[0], v0[1]); w.y = pk_bf16(v0[2], v0[3]); w.z = pk_bf16(v1[0], v1[1]); w.w = pk_bf16(v1[2], v1[3]);
                        *(u32x4*)(rowp + bj * HALF) = w; } } }
    }
};
struct EpiSh2 {
    static constexpr bool PERM = false;
    const bf16_t* X1; float* Z;
    __device__ __forceinline__ void operator()(const f32x4 (&acc)[2][2][4][2], const Unit& u, int wr, int wc, int fr, int fq) const {
#pragma unroll
        for (int ai = 0; ai < 2; ++ai)
#pragma unroll
            for (int m = 0; m < 4; ++m) { const size_t off = (size_t)(u.a0 + ai * HALF + wr * 64 + m * 16 + fr) * D + u.b0 + wc * 32 + 4 * fq;
#pragma unroll
                for (int bj = 0; bj < 2; ++bj)
#pragma unroll
                    for (int n = 0; n < 2; ++n) { const u32x2 xw = *(const u32x2*)(X1 + off + bj * HALF + n * 16);
                        f32x4 xv = {bf_lo(xw.x), bf_hi(xw.x), bf_lo(xw.y), bf_hi(xw.y)};
                        *(f32x4*)(Z + off + bj * HALF + n * 16) = xv * ALPHA + acc[ai][bj][m][n]; } }
    }
};
}

#define XB_TMO      128
#define XB_XCNT(j)  (256  + 64 * (j))
#define XB_XSUB(j)  (1280 + 64 * (j))
#define XB_XGEN(j)  (2304 + 64 * (j))
#define XB_TOP      3328
#define XB_TOPGEN   3392
#define XCD_BAR_WORDS 3456
#define XB_SPIN_CAP (1u << 18)
__device__ __forceinline__ unsigned xb_ld(unsigned* p)              { return __hip_atomic_load(p, __ATOMIC_RELAXED, __HIP_MEMORY_SCOPE_AGENT); }
__device__ __forceinline__ unsigned xb_add(unsigned* p, unsigned v) { return __hip_atomic_fetch_add(p, v, __ATOMIC_RELAXED, __HIP_MEMORY_SCOPE_AGENT); }
__device__ __forceinline__ unsigned xb_xcc_id() { return (unsigned)__builtin_amdgcn_s_getreg((3 << 11) | 20) & 0xFu; }
#define XB_SPIN(cond, bar) do { unsigned _sp = 0; while (cond) { __builtin_amdgcn_s_sleep(1); \
    if ((++_sp & 255u) == 0u) { if (xb_ld(&(bar)[XB_TMO])) break; if (_sp > XB_SPIN_CAP) { atomicAdd(&(bar)[XB_TMO], 1u); break; } } } } while (0)
struct XcdBarrier { unsigned* bar; unsigned x; volatile LAS unsigned* st; };
__device__ __forceinline__ XcdBarrier xcd_barrier_post(unsigned* bar, volatile LAS unsigned* st) {
    XcdBarrier b; b.bar = bar; b.x = xb_xcc_id(); b.st = st;
    if (threadIdx.x == 0) (void)xb_add(&bar[XB_XCNT(b.x)], 1u);
    return b;
}
__device__ __forceinline__ void xcd_barrier_complete(unsigned* bar, unsigned x, unsigned& nloc, unsigned& nx) {
    const unsigned G = gridDim.x * gridDim.y * gridDim.z;
    unsigned sum, cnt, mine, sp = 0u;
    for (;;) {
        sum = 0u; cnt = 0u; mine = 0u;
#pragma unroll
        for (unsigned j = 0; j < 16; ++j) { const unsigned c = xb_ld(&bar[XB_XCNT(j)]); sum += c; cnt += (c > 0u) ? 1u : 0u; mine = (j == x) ? c : mine; }
        if (sum == G) break;
        __builtin_amdgcn_s_sleep(1);
        if ((++sp & 255u) == 0u) { if (xb_ld(&bar[XB_TMO])) break; if (sp > XB_SPIN_CAP) { atomicAdd(&bar[XB_TMO], 1u); break; } }
    }
    nloc = mine > 0u ? mine : 1u; nx = cnt > 0u ? cnt : 1u;
}
__device__ __forceinline__ void xcd_barrier(const XcdBarrier& b) {
    asm volatile("s_waitcnt vmcnt(0)" ::: "memory");
    __syncthreads();
    if (threadIdx.x == 0) {
        unsigned* bar = b.bar;
        __builtin_amdgcn_s_waitcnt(0);
        unsigned nloc = b.st[0], nx = b.st[1];
        if (nloc == 0u) { xcd_barrier_complete(bar, b.x, nloc, nx); b.st[0] = nloc; b.st[1] = nx; }
        const unsigned old = xb_add(&bar[XB_XSUB(b.x)], 1u);
        const unsigned gen = old / nloc;
        if (old + 1u == (gen + 1u) * nloc) {
            __builtin_amdgcn_fence(__ATOMIC_RELEASE, "agent");
            asm volatile("s_waitcnt vmcnt(0)" ::: "memory");
            const unsigned og = xb_add(&bar[XB_TOP], 1u);
            const unsigned tg = og / nx;
            if (og + 1u == (tg + 1u) * nx) xb_add(&bar[XB_TOPGEN], 1u);
            else XB_SPIN(xb_ld(&bar[XB_TOPGEN]) == tg, bar);
            __builtin_amdgcn_fence(__ATOMIC_ACQUIRE, "agent");
            xb_add(&bar[XB_XGEN(b.x)], 1u);
            asm volatile("s_waitcnt vmcnt(0)" ::: "memory");
        } else {
            XB_SPIN(xb_ld(&bar[XB_XGEN(b.x)]) == gen, bar);
            __builtin_amdgcn_fence(__ATOMIC_ACQUIRE, "agent");
            asm volatile("s_waitcnt vmcnt(0)" ::: "memory");
        }
    }
    __syncthreads();
}

struct Frame {
    LAS unsigned char* lds;
    volatile LAS unsigned* MISC;
    unsigned* ctl;
    int tid, lane, wave, vcu, G, bx;
    const float* const* in; float* outp; unsigned char* ws;
    __device__ __forceinline__ const float* x() const { return in[0]; }
    __device__ __forceinline__ const float* w_in() const { return in[1]; }
    __device__ __forceinline__ const float* conv_w() const { return in[2]; }
    __device__ __forceinline__ const float* conv_b() const { return in[3]; }
    __device__ __forceinline__ const float* lru_wa() const { return in[4]; }
    __device__ __forceinline__ const float* lru_ba() const { return in[5]; }
    __device__ __forceinline__ const float* lru_wx() const { return in[6]; }
    __device__ __forceinline__ const float* lru_bx() const { return in[7]; }
    __device__ __forceinline__ const float* lru_lambda() const { return in[8]; }
    __device__ __forceinline__ const float* pool_w() const { return in[9]; }
    __device__ __forceinline__ const float* pool_scale() const { return in[10]; }
    __device__ __forceinline__ const float* w_out() const { return in[11]; }
    __device__ __forceinline__ const float* ln1_g() const { return in[12]; }
    __device__ __forceinline__ const float* ln1_b() const { return in[13]; }
    __device__ __forceinline__ const float* router_w() const { return in[14]; }
    __device__ __forceinline__ const float* router_bias() const { return in[15]; }
    __device__ __forceinline__ const float* exp_w1() const { return in[16]; }
    __device__ __forceinline__ const float* exp_w3() const { return in[17]; }
    __device__ __forceinline__ const float* exp_w2() const { return in[18]; }
    __device__ __forceinline__ const float* sh_w1() const { return in[19]; }
    __device__ __forceinline__ const float* sh_w3() const { return in[20]; }
    __device__ __forceinline__ const float* sh_w2() const { return in[21]; }
    __device__ __forceinline__ const float* ln2_g() const { return in[22]; }
    __device__ __forceinline__ const float* ln2_b() const { return in[23]; }
    __device__ __forceinline__ float* out() const { return outp; }
    __device__ __forceinline__ bf16_t* GW() const { return (bf16_t*)(ws + WS_GW); }
    __device__ __forceinline__ bf16_t* PW() const { return (bf16_t*)(ws + WS_PW); }
    __device__ __forceinline__ bf16_t* WIN() const { return (bf16_t*)(ws + WS_WIN); }
    __device__ __forceinline__ bf16_t* WOUT() const { return (bf16_t*)(ws + WS_WOUT); }
    __device__ __forceinline__ bf16_t* WRS() const { return (bf16_t*)(ws + WS_WRS); }
    __device__ __forceinline__ bf16_t* WS2() const { return (bf16_t*)(ws + WS_WS2); }
    __device__ __forceinline__ bf16_t* EW2() const { return (bf16_t*)(ws + WS_EW2); }
    __device__ __forceinline__ bf16_t* EW13() const { return (bf16_t*)(ws + WS_EW13); }
    __device__ __forceinline__ bf16_t* XB() const { return (bf16_t*)(ws + WS_XB); }
    __device__ __forceinline__ bf16_t* PROJ() const { return (bf16_t*)(ws + WS_PROJ); }
    __device__ __forceinline__ bf16_t* Y() const { return (bf16_t*)(ws + WS_Y); }
    __device__ __forceinline__ bf16_t* X1() const { return (bf16_t*)(ws + WS_X1); }
    __device__ __forceinline__ bf16_t* HS() const { return (bf16_t*)(ws + WS_HS); }
    __device__ __forceinline__ bf16_t* HE() const { return (bf16_t*)(ws + WS_HE); }
    __device__ __forceinline__ bf16_t* YS() const { return (bf16_t*)(ws + WS_YS); }
    __device__ __forceinline__ float* AGG() const { return (float*)(ws + WS_AGG); }
    __device__ __forceinline__ float* Z1() const { return (float*)(ws + WS_Z1); }
    __device__ __forceinline__ float* LOGIT() const { return (float*)(ws + WS_LOGIT); }
    __device__ __forceinline__ float* GATEV() const { return (float*)(ws + WS_GATEV); }
    __device__ __forceinline__ float* SGATE() const { return (float*)(ws + WS_SGATE); }
    __device__ __forceinline__ int* CNT() const { return (int*)(ws + WS_CNT); }
    __device__ __forceinline__ int* TILE() const { return (int*)(ws + WS_TILE); }
    __device__ __forceinline__ int* NTILES() const { return (int*)(ws + WS_TILE + 64 * KiB); }
    __device__ __forceinline__ int* IDX() const { return (int*)(ws + WS_IDX); }
    __device__ __forceinline__ int* POS() const { return (int*)(ws + WS_POS); }
    __device__ __forceinline__ int* STOK() const { return (int*)(ws + WS_STOK); }
};

__device__ __forceinline__ void p0_transpose_item(const float* W, int K, int N, bf16_t* WT, int k0, int n0, int drow0, LAS float* scr, int lane) {
#pragma unroll 8
    for (int i = 0; i < 32; ++i) { const int kk = 2 * i + (lane >> 5); scr[kk * 33 + (lane & 31)] = W[(size_t)(k0 + kk) * N + n0 + (lane & 31)]; }
    asm volatile("s_waitcnt lgkmcnt(0)" ::: "memory");
    const int c = lane & 7;
#pragma unroll
    for (int j = 0; j < 4; ++j) { const int n = (lane >> 3) + 8 * j; const LAS float* s = scr + (8 * c) * 33 + n;
        u32x4 o; o.x = pk_bf16(s[0 * 33], s[1 * 33]); o.y = pk_bf16(s[2 * 33], s[3 * 33]); o.z = pk_bf16(s[4 * 33], s[5 * 33]); o.w = pk_bf16(s[6 * 33], s[7 * 33]);
        *(u32x4*)(WT + (size_t)(drow0 + n) * K + k0 + 8 * c) = o; }
    asm volatile("s_waitcnt lgkmcnt(0)" ::: "memory");
}
__device__ __forceinline__ int ileave(int n0) { return (n0 >> 7) * 256 + (n0 & 127); }
__device__ __forceinline__ void p0_prologue(Frame& F) {
    LAS float* scr = (LAS float*)(F.lds + F.wave * 16384);
    const int gw = F.vcu * NWAVES + F.wave, NGW = F.G * NWAVES, lane = F.lane;
    constexpr int I_WIN = 16 * 48, I_WOUT = 16 * 32, I_R = 16 * 8, I_S2 = 4 * 32, I_SMALL = I_WIN + I_WOUT + 3 * I_R + I_S2;
    for (int it = gw; it < I_SMALL; it += NGW) {
        int r = it;
        if (r < I_WIN) { const int kb = r / 48, nb = r % 48; p0_transpose_item(F.w_in(), D, NPROJ, F.WIN(), 64 * kb, 32 * nb, 32 * nb, scr, lane); continue; } r -= I_WIN;
        if (r < I_WOUT) { const int kb = r / 32, nb = r % 32; p0_transpose_item(F.w_out(), D, D, F.WOUT(), 64 * kb, 32 * nb, 32 * nb, scr, lane); continue; } r -= I_WOUT;
        if (r < I_R) { const int kb = r / 8, nb = r % 8; p0_transpose_item(F.router_w(), D, NE, F.WRS(), 64 * kb, 32 * nb, 32 * nb, scr, lane); continue; } r -= I_R;
        if (r < I_R) { const int kb = r / 8, nb = r % 8; p0_transpose_item(F.sh_w1(), D, DE, F.WRS(), 64 * kb, 32 * nb, 256 + ileave(32 * nb), scr, lane); continue; } r -= I_R;
        if (r < I_R) { const int kb = r / 8, nb = r % 8; p0_transpose_item(F.sh_w3(), D, DE, F.WRS(), 64 * kb, 32 * nb, 256 + ileave(32 * nb) + 128, scr, lane); continue; } r -= I_R;
        { const int kb = r / 32, nb = r % 32; p0_transpose_item(F.sh_w2(), DE, D, F.WS2(), 64 * kb, 32 * nb, 32 * nb, scr, lane); }
    }
    for (int it = gw; it < NE * 384; it += NGW) {
        const int e = it / 384; int r = it % 384;
        if (r < 128) { const int kb = r / 8, nb = r % 8; p0_transpose_item(F.exp_w1() + (size_t)e * D * DE, D, DE, F.EW13(), 64 * kb, 32 * nb, e * 512 + ileave(32 * nb), scr, lane); continue; } r -= 128;
        if (r < 128) { const int kb = r / 8, nb = r % 8; p0_transpose_item(F.exp_w3() + (size_t)e * D * DE, D, DE, F.EW13(), 64 * kb, 32 * nb, e * 512 + ileave(32 * nb) + 128, scr, lane); continue; } r -= 128;
        { const int kb = r / 32, nb = r % 32; p0_transpose_item(F.exp_w2() + (size_t)e * DE * D, DE, D, F.EW2(), 64 * kb, 32 * nb, e * 1024 + 32 * nb, scr, lane); }
    }
    { const size_t n8 = (size_t)T * D / 8; const size_t stride = (size_t)F.G * NT;
      for (size_t i = (size_t)F.vcu * NT + F.tid; i < n8; i += stride) { const f32x4 a = ((const f32x4*)F.x())[2 * i], b = ((const f32x4*)F.x())[2 * i + 1];
          u32x4 w; w.x = pk_bf16(a[0], a[1]); w.y = pk_bf16(a[2], a[3]); w.z = pk_bf16(b[0], b[1]); w.w = pk_bf16(b[2], b[3]); ((u32x4*)F.XB())[i] = w; } }
    { const int gt = F.vcu * NT + F.tid, ngt = F.G * NT;
      for (int f = gt; f < NHEAD * 8 * 2 * 64; f += ngt) { const int ln = f & 63, ks = (f >> 6) & 1, n = (f >> 7) & 7, h = f >> 10; const int i = ln & 15, q = ln >> 4, nn = n & 3;
          const int oc = 32 * (nn >> 1) + 8 * (i >> 2) + 4 * (nn & 1) + (i & 3); const float* W = (n < 4 ? F.lru_wa() : F.lru_wx()) + (size_t)h * HD * HD;
          float v[8];
#pragma unroll
          for (int j = 0; j < 8; ++j) v[j] = W[(size_t)(32 * ks + 8 * q + j) * HD + oc];
          u32x4 w; w.x = pk_bf16(v[0], v[1]); w.y = pk_bf16(v[2], v[3]); w.z = pk_bf16(v[4], v[5]); w.w = pk_bf16(v[6], v[7]); ((u32x4*)F.GW())[f] = w; }
      for (int f = gt; f < PG * 8 * 4 * 64; f += ngt) { const int ln = f & 63, ks = (f >> 6) & 3, n = (f >> 8) & 7, g = f >> 11; const int i = ln & 15, q = ln >> 4;
          const int oc = 32 * (n >> 1) + 8 * (i >> 2) + 4 * (n & 1) + (i & 3); const float* W = F.pool_w() + (size_t)g * PGD * PGD;
          float v[8];
#pragma unroll
          for (int j = 0; j < 8; ++j) v[j] = W[(size_t)(32 * ks + 8 * q + j) * PGD + oc];
          u32x4 w; w.x = pk_bf16(v[0], v[1]); w.y = pk_bf16(v[2], v[3]); w.z = pk_bf16(v[4], v[5]); w.w = pk_bf16(v[6], v[7]); ((u32x4*)F.PW())[f] = w; } }
}

template <int PASS>
__device__ __forceinline__ void mixer_phase(Frame& F) {
    LAS float* PRM = (LAS float*)(F.lds);
    for (int c = F.tid; c < DL; c += NT) {
        PRM[0 * DL + c] = F.conv_w()[0 * DL + c]; PRM[1 * DL + c] = F.conv_w()[1 * DL + c]; PRM[2 * DL + c] = F.conv_w()[2 * DL + c]; PRM[3 * DL + c] = F.conv_w()[3 * DL + c];
        PRM[4 * DL + c] = F.conv_b()[c]; PRM[5 * DL + c] = F.lru_ba()[c]; PRM[6 * DL + c] = F.lru_bx()[c];
        const float lam = F.lru_lambda()[c]; const float sp = (lam < -20.f) ? -lam : log1pf(expf(-lam)); PRM[7 * DL + c] = 8.0f * LOG2E * sp;
    }
    __syncthreads();
    const int h = F.wave, lane = F.lane, fr = lane & 15, fq = lane >> 4;
    bf16x8 gwf[8][2];
#pragma unroll
    for (int n = 0; n < 8; ++n)
#pragma unroll
        for (int ks = 0; ks < 2; ++ks) gwf[n][ks] = ((const bf16x8*)F.GW())[((h * 8 + n) * 2 + ks) * 64 + lane];
    for (int tile = F.vcu; tile < T / TT; tile += F.G) {
        const int t0 = tile * TT, s0 = t0 & (SEQ - 1);
        float hc[2][8], ap[2][8];
#pragma unroll
        for (int ks = 0; ks < 2; ++ks)
#pragma unroll
            for (int j = 0; j < 8; ++j) { hc[ks][j] = 0.f; ap[ks][j] = 1.f; }
        if (PASS == 2) {
            const int nprev = s0 / TT;
            for (int c = tile - nprev; c < tile; ++c) {
#pragma unroll
                for (int ks = 0; ks < 2; ++ks) { const float* ag = F.AGG() + (size_t)c * 2 * DL + 64 * h + 32 * ks + 8 * fq;
                    const f32x4 a0 = *(const f32x4*)(ag), a1 = *(const f32x4*)(ag + 4), b0 = *(const f32x4*)(ag + DL), b1 = *(const f32x4*)(ag + DL + 4);
#pragma unroll
                    for (int j = 0; j < 4; ++j) { hc[ks][j] = a0[j] * hc[ks][j] + b0[j]; hc[ks][4 + j] = a1[j] * hc[ks][4 + j] + b1[j]; } }
            }
        }
        for (int m = 0; m < TT / 16; ++m) {
            asm volatile("" ::: "memory");
            const int t = t0 + 16 * m + fr, s = s0 + 16 * m + fr;
            float uc[2][8]; bf16x8 af[2];
#pragma unroll
            for (int ks = 0; ks < 2; ++ks) {
                const int ch = 64 * h + 32 * ks + 8 * fq;
                const bf16_t* up = F.PROJ() + (size_t)t * NPROJ + ch;
                const u32x4 z4 = {0u, 0u, 0u, 0u};
                const u32x4 r3 = *(const u32x4*)up;
                const u32x4 r2 = (s >= 1) ? *(const u32x4*)(up - 1 * NPROJ) : z4;
                const u32x4 r1 = (s >= 2) ? *(const u32x4*)(up - 2 * NPROJ) : z4;
                const u32x4 r0 = (s >= 3) ? *(const u32x4*)(up - 3 * NPROJ) : z4;
                float w0[8], w1[8], w2[8], w3[8], cb[8];
#pragma unroll
                for (int q = 0; q < 2; ++q) { const f32x4 a = *(const LAS f32x4*)(PRM + 0 * DL + ch + 4 * q), b = *(const LAS f32x4*)(PRM + 1 * DL + ch + 4 * q), c = *(const LAS f32x4*)(PRM + 2 * DL + ch + 4 * q),
                                                    d = *(const LAS f32x4*)(PRM + 3 * DL + ch + 4 * q), e = *(const LAS f32x4*)(PRM + 4 * DL + ch + 4 * q);
#pragma unroll
                    for (int j = 0; j < 4; ++j) { w0[4 * q + j] = a[j]; w1[4 * q + j] = b[j]; w2[4 * q + j] = c[j]; w3[4 * q + j] = d[j]; cb[4 * q + j] = e[j]; } }
#pragma unroll
                for (int j = 0; j < 8; ++j) uc[ks][j] = cb[j] + w0[j] * bf_get(r0, j) + w1[j] * bf_get(r1, j) + w2[j] * bf_get(r2, j) + w3[j] * bf_get(r3, j);
                u32x4 pk; pk.x = pk_bf16(uc[ks][0], uc[ks][1]); pk.y = pk_bf16(uc[ks][2], uc[ks][3]); pk.z = pk_bf16(uc[ks][4], uc[ks][5]); pk.w = pk_bf16(uc[ks][6], uc[ks][7]);
                af[ks] = __builtin_bit_cast(bf16x8, pk);
            }
            f32x4 acc[8];
#pragma unroll
            for (int n = 0; n < 8; ++n) { acc[n] = (f32x4){0.f, 0.f, 0.f, 0.f};
#pragma unroll
                for (int ks = 0; ks < 2; ++ks) acc[n] = __builtin_amdgcn_mfma_f32_16x16x32_bf16(gwf[n][ks], af[ks], acc[n], 0, 0, 0); }
#pragma unroll
            for (int ks = 0; ks < 2; ++ks) {
                const int ch = 64 * h + 32 * ks + 8 * fq;
                float ba[8], bx[8], sp[8];
#pragma unroll
                for (int q = 0; q < 2; ++q) { const f32x4 a = *(const LAS f32x4*)(PRM + 5 * DL + ch + 4 * q), b = *(const LAS f32x4*)(PRM + 6 * DL + ch + 4 * q), c = *(const LAS f32x4*)(PRM + 7 * DL + ch + 4 * q);
#pragma unroll
                    for (int j = 0; j < 4; ++j) { ba[4 * q + j] = a[j]; bx[4 * q + j] = b[j]; sp[4 * q + j] = c[j]; } }
                u32x4 gt = {0u, 0u, 0u, 0u};
                if (PASS == 2) gt = *(const u32x4*)(F.PROJ() + (size_t)t * NPROJ + DL + ch);
                float yv[8];
#pragma unroll
                for (int j = 0; j < 8; ++j) {
                    const float rpre = acc[2 * ks + (j >> 2)][j & 3] + ba[j], ipre = acc[4 + 2 * ks + (j >> 2)][j & 3] + bx[j];
                    const float r = fast_sigmoid(rpre), ig = fast_sigmoid(ipre);
                    float a = __builtin_amdgcn_exp2f(-sp[j] * r);
                    float mult = __builtin_amdgcn_sqrtf(fmaxf(1.0f - a * a, 0.f)); if (s == 0) mult = 1.0f;
                    float b = mult * ig * uc[ks][j];
                    { const float as = dppf<0x111>(1.f, a), bs = dppf<0x111>(0.f, b); b = a * bs + b; a = a * as; }
                    { const float as = dppf<0x112>(1.f, a), bs = dppf<0x112>(0.f, b); b = a * bs + b; a = a * as; }
                    { const float as = dppf<0x114>(1.f, a), bs = dppf<0x114>(0.f, b); b = a * bs + b; a = a * as; }
                    { const float as = dppf<0x118>(1.f, a), bs = dppf<0x118>(0.f, b); b = a * bs + b; a = a * as; }
                    const float hv = a * hc[ks][j] + b;
                    hc[ks][j] = dppf<0x15F>(0.f, hv);
                    if (PASS == 1) ap[ks][j] *= dppf<0x15F>(0.f, a);
                    if (PASS == 2) yv[j] = hv * gelu_tanh(bf_get(gt, j));
                }
                if (PASS == 2) { u32x4 o; o.x = pk_bf16(yv[0], yv[1]); o.y = pk_bf16(yv[2], yv[3]); o.z = pk_bf16(yv[4], yv[5]); o.w = pk_bf16(yv[6], yv[7]);
                    *(u32x4*)(F.Y() + (size_t)t * D + ch) = o; }
            }
        }
        if (PASS == 1 && fr == 0) {
#pragma unroll
            for (int ks = 0; ks < 2; ++ks) { float* ag = F.AGG() + (size_t)tile * 2 * DL + 64 * h + 32 * ks + 8 * fq;
                *(f32x4*)(ag) = (f32x4){ap[ks][0], ap[ks][1], ap[ks][2], ap[ks][3]}; *(f32x4*)(ag + 4) = (f32x4){ap[ks][4], ap[ks][5], ap[ks][6], ap[ks][7]};
                *(f32x4*)(ag + DL) = (f32x4){hc[ks][0], hc[ks][1], hc[ks][2], hc[ks][3]}; *(f32x4*)(ag + DL + 4) = (f32x4){hc[ks][4], hc[ks][5], hc[ks][6], hc[ks][7]}; }
        }
        if (PASS == 2) {
            const int g = h >> 1, nh = h & 1, W = 2 << g;
            bf16x8 pwf[4][4];
#pragma unroll
            for (int n = 0; n < 4; ++n)
#pragma unroll
                for (int ks = 0; ks < 4; ++ks) pwf[n][ks] = ((const bf16x8*)F.PW())[((g * 8 + 4 * nh + n) * 4 + ks) * 64 + lane];
            float psc[4][4];
#pragma unroll
            for (int n = 0; n < 4; ++n) { const f32x4 sv = *(const f32x4*)(F.pool_scale() + 128 * g + 64 * nh + 32 * (n >> 1) + 8 * fq + 4 * (n & 1));
#pragma unroll
                for (int j = 0; j < 4; ++j) psc[n][j] = sv[j]; }
            for (int m = 0; m < TT / 16; ++m) {
                const int t = t0 + 16 * m + fr, s = s0 + 16 * m + fr;
                const int cnt = (s + 1 < W) ? (s + 1) : W; const float rc = 1.0f / (float)cnt;
                f32x4 acc[4];
#pragma unroll
                for (int n = 0; n < 4; ++n) acc[n] = (f32x4){0.f, 0.f, 0.f, 0.f};
#pragma unroll
                for (int ks = 0; ks < 4; ++ks) {
                    const bf16_t* vp = F.PROJ() + (size_t)t * NPROJ + 2 * DL + 128 * g + 32 * ks + 8 * fq;
                    const u32x4 z4 = {0u, 0u, 0u, 0u};
                    const u32x4 cw = *(const u32x4*)vp; const u32x4 pw_ = (s >= 16) ? *(const u32x4*)(vp - 16 * NPROJ) : z4;
                    float pl[8];
#pragma unroll
                    for (int j = 0; j < 8; ++j) {
                        const float v0 = bf_get(cw, j); float c = v0, p = bf_get(pw_, j);
                        { const float x = dppf<0x111>(dppf<0x121>(0.f, p), c); p = p + dppf<0x111>(0.f, p); c = c + x; }
                        if (g >= 1) { const float x = dppf<0x112>(dppf<0x122>(0.f, p), c); p = p + dppf<0x112>(0.f, p); c = c + x; }
                        if (g >= 2) { const float x = dppf<0x114>(dppf<0x124>(0.f, p), c); p = p + dppf<0x114>(0.f, p); c = c + x; }
                        if (g >= 3) { const float x = dppf<0x118>(dppf<0x128>(0.f, p), c); c = c + x; }
                        pl[j] = c * rc - v0;
                    }
                    u32x4 pk; pk.x = pk_bf16(pl[0], pl[1]); pk.y = pk_bf16(pl[2], pl[3]); pk.z = pk_bf16(pl[4], pl[5]); pk.w = pk_bf16(pl[6], pl[7]);
                    const bf16x8 fa = __builtin_bit_cast(bf16x8, pk);
#pragma unroll
                    for (int n = 0; n < 4; ++n) acc[n] = __builtin_amdgcn_mfma_f32_16x16x32_bf16(pwf[n][ks], fa, acc[n], 0, 0, 0);
                }
#pragma unroll
                for (int p2 = 0; p2 < 2; ++p2) { const f32x4 v0 = acc[2 * p2], v1 = acc[2 * p2 + 1];
                    u32x4 o; o.x = pk_bf16(v0[0] * psc[2 * p2][0], v0[1] * psc[2 * p2][1]); o.y = pk_bf16(v0[2] * psc[2 * p2][2], v0[3] * psc[2 * p2][3]);
                    o.z = pk_bf16(v1[0] * psc[2 * p2 + 1][0], v1[1] * psc[2 * p2 + 1][1]); o.w = pk_bf16(v1[2] * psc[2 * p2 + 1][2], v1[3] * psc[2 * p2 + 1][3]);
                    *(u32x4*)(F.Y() + (size_t)t * D + DL + 128 * g + 64 * nh + 32 * p2 + 8 * fq) = o; }
            }
        }
    }
    __syncthreads();
}

__device__ __forceinline__ void ln1_phase(Frame& F) {
    const int gw = F.vcu * NWAVES + F.wave, NGW = F.G * NWAVES, lane = F.lane;
    f32x4 gv[4], bv[4];
#pragma unroll
    for (int j = 0; j < 4; ++j) { gv[j] = ((const f32x4*)F.ln1_g())[lane + 64 * j]; bv[j] = ((const f32x4*)F.ln1_b())[lane + 64 * j]; }
    for (int m = gw; m < T; m += NGW) {
        const f32x4* xr = (const f32x4*)(F.Z1() + (size_t)m * D) + lane;
        f32x4 v[4]; float s = 0.f;
#pragma unroll
        for (int j = 0; j < 4; ++j) { v[j] = xr[64 * j]; s += (v[j][0] + v[j][1]) + (v[j][2] + v[j][3]); }
        const float mean = wave_sum(s) * (1.f / D); float s2 = 0.f;
#pragma unroll
        for (int j = 0; j < 4; ++j) { v[j] = v[j] - mean; s2 += (v[j][0] * v[j][0] + v[j][1] * v[j][1]) + (v[j][2] * v[j][2] + v[j][3] * v[j][3]); }
        const float rstd = 1.f / sqrtf(wave_sum(s2) * (1.f / D) + LN_EPS);
        u32x2* o8 = (u32x2*)(F.X1() + (size_t)m * D) + lane;
#pragma unroll
        for (int j = 0; j < 4; ++j) { const f32x4 y = v[j] * rstd * gv[j] + bv[j]; u32x2 w; w.x = pk_bf16(y[0], y[1]); w.y = pk_bf16(y[2], y[3]); o8[64 * j] = w; }
    }
}

__device__ __forceinline__ void route_phase(Frame& F) {
    LAS int* hist = (LAS int*)(F.lds);
    for (int e = F.tid; e < NE; e += NT) hist[e] = 0;
    __syncthreads();
    const int lane = F.lane, cb = F.bx;
    const f32x4 bias4 = ((const f32x4*)F.router_bias())[lane];
    const float NINF = -__builtin_inff();
    for (int it = 0; it < 128 / NWAVES; ++it) {
        const int t = cb * 128 + it * NWAVES + F.wave;
        const f32x4 lg = ((const f32x4*)(F.LOGIT() + (size_t)t * NE))[lane];
        float sc[4], bv[4];
#pragma unroll
        for (int j = 0; j < 4; ++j) { sc[j] = 1.0f / (1.0f + expf(-lg[j])); bv[j] = sc[j] + bias4[j]; }
        float m1 = fmaxf(bv[0], bv[1]), m2 = fminf(bv[0], bv[1]);
        { const float hi = fmaxf(bv[2], bv[3]), lo = fminf(bv[2], bv[3]); const float n1 = fmaxf(m1, hi), n2 = fmaxf(fminf(m1, hi), fmaxf(m2, lo)); m1 = n1; m2 = n2; }
#pragma unroll
        for (int o = 1; o < 8; o <<= 1) { const float o1 = __shfl_xor(m1, o), o2 = __shfl_xor(m2, o); const float n1 = fmaxf(m1, o1), n2 = fmaxf(fminf(m1, o1), fmaxf(m2, o2)); m1 = n1; m2 = n2; }
        const float gs = m1 + m2; const int g = lane >> 3;
        int rank = 0;
#pragma unroll
        for (int gg = 0; gg < 8; ++gg) { const float og = __shfl(gs, gg * 8); rank += (og > gs || (og == gs && gg < g)) ? 1 : 0; }
        const bool keep = rank < 4;
#pragma unroll
        for (int j = 0; j < 4; ++j) bv[j] = keep ? bv[j] : NINF;
        int myidx = 0; float mys = 0.f, ssum = 0.f;
        for (int k = 0; k < TOPK; ++k) {
            float cv = bv[0]; int ci = 0; float cs = sc[0];
#pragma unroll
            for (int j = 1; j < 4; ++j) if (bv[j] > cv) { cv = bv[j]; ci = j; cs = sc[j]; }
            ci += 4 * lane;
#pragma unroll
            for (int o = 32; o >= 1; o >>= 1) { const float ov = __shfl_xor(cv, o); const int oi = __shfl_xor(ci, o); const float os = __shfl_xor(cs, o);
                if (ov > cv || (ov == cv && oi < ci)) { cv = ov; ci = oi; cs = os; } }
            ssum += cs;
            if (lane == k) { myidx = ci; mys = cs; }
            if (lane == (ci >> 2)) {
#pragma unroll
                for (int j = 0; j < 4; ++j) if ((ci & 3) == j) bv[j] = NINF;
            }
        }
        if (lane < TOPK) {
            const int rk = __hip_atomic_fetch_add(&hist[myidx], 1, __ATOMIC_RELAXED, __HIP_MEMORY_SCOPE_WORKGROUP);
            F.IDX()[t * TOPK + lane] = myidx; F.GATEV()[t * TOPK + lane] = mys / ssum * ROUTED_SCALE; F.POS()[t * TOPK + lane] = rk;
        }
    }
    __syncthreads();
    for (int e = F.tid; e < NE; e += NT) F.CNT()[cb * NE + e] = hist[e];
    __syncthreads();
}

__device__ __forceinline__ void dispatch_phase(Frame& F) {
    LAS int* tot = (LAS int*)(F.lds); LAS int* pre = tot + NE; LAS int* start = pre + NE;
    const int cb = F.bx;
    if (F.tid < NE) { const int e = F.tid; int ts = 0, ps = 0;
        for (int c = 0; c < 256; ++c) { const int v = F.CNT()[c * NE + e]; ts += v; ps += (c < cb) ? v : 0; }
        tot[e] = ts; pre[e] = ps; }
    __syncthreads();
    if (F.tid < NE) { int s = 0; for (int e = 0; e < F.tid; ++e) s += tot[e]; start[F.tid] = s; }
    __syncthreads();
    for (int i = F.tid; i < 128 * TOPK; i += NT) { const int a = cb * 128 * TOPK + i; const int e = F.IDX()[a]; const int pos = start[e] + pre[e] + F.POS()[a];
        F.POS()[a] = pos; F.STOK()[pos] = a >> 3; F.SGATE()[pos] = F.GATEV()[a]; }
    if (cb == 0 && F.tid < NE) { const int e = F.tid; int ts = 0; for (int q = 0; q < e; ++q) ts += (tot[q] + 255) >> 8; const int nte = (tot[e] + 255) >> 8;
        for (int i = 0; i < nte; ++i) { const int rem = tot[e] - 256 * i; ((i32x4*)F.TILE())[ts + i] = (i32x4){start[e] + 256 * i, rem < 256 ? rem : 256, e, 0}; }
        if (e == NE - 1) *F.NTILES() = ts + nte; }
    __syncthreads();
}

template <int NPN, bool GATHER>
__device__ __forceinline__ int group_preload(Frame& F, int rows_per_expert) {
    LAS i32x4* UT = (LAS i32x4*)(F.lds + UT_OFF); LAS unsigned short* ROWS = (LAS unsigned short*)(F.lds + ROWS_OFF);
    const int ntiles = ld_agent_i(F.NTILES()); const int nunits = ntiles * NPN; const int n_my = (F.vcu < nunits) ? (nunits - F.vcu + 255) / 256 : 0;
    for (int k = F.tid; k < n_my; k += NT) { const int L = k * 256 + F.vcu, tile = L / NPN, pn = L % NPN; const i32x4 te = ((const i32x4*)F.TILE())[tile];
        UT[k] = (i32x4){te.x, te.y, te.z * rows_per_expert + pn * 256, pn}; }
    __syncthreads();
    if (GATHER) {
        for (int i = F.tid; i < n_my * 256; i += NT) { const int k = i >> 8, r = i & 255; const i32x4 e = UT[k]; const int rr = r < e.y ? r : e.y - 1; ROWS[i] = (unsigned short)F.STOK()[e.x + rr]; }
        __syncthreads();
    }
    return n_my;
}

__device__ __forceinline__ void combine_phase(Frame& F) {
    const int gw = F.vcu * NWAVES + F.wave, NGW = F.G * NWAVES, lane = F.lane;
    f32x4 gv[4], bv[4];
#pragma unroll
    for (int j = 0; j < 4; ++j) { gv[j] = ((const f32x4*)F.ln2_g())[lane + 64 * j]; bv[j] = ((const f32x4*)F.ln2_b())[lane + 64 * j]; }
    for (int m = gw; m < T; m += NGW) {
        f32x4* xr = (f32x4*)(F.out() + (size_t)m * D) + lane;
        f32x4 v[4];
#pragma unroll
        for (int j = 0; j < 4; ++j) v[j] = xr[64 * j];
        int pos = 0; if (lane < TOPK) pos = F.POS()[m * TOPK + lane];
#pragma unroll
        for (int k = 0; k < TOPK; ++k) { const int p = __shfl(pos, k); const u32x2* yr = (const u32x2*)(F.YS() + (size_t)p * D) + lane;
#pragma unroll
            for (int j = 0; j < 4; ++j) { const u32x2 w = yr[64 * j]; v[j][0] += bf_lo(w.x); v[j][1] += bf_hi(w.x); v[j][2] += bf_lo(w.y); v[j][3] += bf_hi(w.y); } }
        float s = 0.f;
#pragma unroll
        for (int j = 0; j < 4; ++j) s += (v[j][0] + v[j][1]) + (v[j][2] + v[j][3]);
        const float mean = wave_sum(s) * (1.f / D); float s2 = 0.f;
#pragma unroll
        for (int j = 0; j < 4; ++j) { v[j] = v[j] - mean; s2 += (v[j][0] * v[j][0] + v[j][1] * v[j][1]) + (v[j][2] * v[j][2] + v[j][3] * v[j][3]); }
        const float rstd = 1.f / sqrtf(wave_sum(s2) * (1.f / D) + LN_EPS);
#pragma unroll
        for (int j = 0; j < 4; ++j) xr[64 * j] = v[j] * rstd * gv[j] + bv[j];
    }
}

struct Args { const float* in[24]; float* out; unsigned char* ws; int ph_lo, ph_hi, li, pad; };
__global__ void __launch_bounds__(NT, 2) fwd_kernel(Args args) {
    extern __shared__ __attribute__((aligned(16))) unsigned char lds_raw[];
    Frame F;
    F.lds = (LAS unsigned char*)lds_raw;
    F.MISC = (volatile LAS unsigned*)(F.lds + MISC_OFF);
    F.tid = threadIdx.x; F.lane = F.tid & 63; F.wave = __builtin_amdgcn_readfirstlane(F.tid >> 6);
    F.G = gridDim.x; F.bx = blockIdx.x; F.vcu = (F.G % 8 == 0) ? (F.bx % 8) * (F.G / 8) + F.bx / 8 : F.bx;
    F.ws = args.ws; F.in = args.in; F.outp = args.out;
    F.ctl = (unsigned*)(F.ws + WS_CTL);
    for (int u = F.tid; u < (LDS_BYTES - RING_BYTES) / 4; u += NT) ((LAS unsigned*)(F.lds + RING_BYTES))[u] = 0u;
    __syncthreads();
    XcdBarrier bar; bar.bar = (unsigned*)(F.ctl + CW_BAR); bar.x = 0; bar.st = nullptr;
    if (N_LAUNCHES == 1) bar = xcd_barrier_post((unsigned*)(F.ctl + CW_BAR), F.MISC + 8);
#define GRID_BAR() do { if (N_LAUNCHES == 1) xcd_barrier(bar); } while (0)
    const int lo = args.ph_lo, hi = args.ph_hi;
#ifndef PH_MASK
#define PH_MASK 0x1fff
#endif
#define IN(k) (((PH_MASK >> (k)) & 1) && lo <= (k) && (k) < hi)
#define BOTH(k) (IN(k) && IN((k) + 1))
    LAS unsigned char* ring = F.lds;

    if (IN(0)) { p0_prologue(F); if (BOTH(0)) GRID_BAR(); }
    if (IN(1)) { pg8::DenseOrder S; S.init(T, NPROJ, F.G, F.bx); pg8::EpiProj E{F.PROJ()};
        pg8::gemm_phase<pg8::EpiProj, pg8::DenseOrder, false, true>(ring, F.XB(), F.WIN(), D, S, E); if (BOTH(1)) GRID_BAR(); }
    if (IN(2)) { mixer_phase<1>(F); if (BOTH(2)) GRID_BAR(); }
    if (IN(3)) { mixer_phase<2>(F); if (BOTH(3)) GRID_BAR(); }
    if (IN(4)) { pg8::DenseOrder S; S.init(T, D, F.G, F.bx); pg8::EpiMix E{F.x(), F.Z1()};
        pg8::gemm_phase<pg8::EpiMix, pg8::DenseOrder, false, true>(ring, F.Y(), F.WOUT(), D, S, E); if (BOTH(4)) GRID_BAR(); }
    if (IN(5)) { ln1_phase(F); if (BOTH(5)) GRID_BAR(); }
    if (IN(6)) { pg8::DenseOrder S; S.init(T, 768, F.G, F.bx); pg8::EpiRS E{F.LOGIT(), F.HS()};
        pg8::gemm_phase<pg8::EpiRS, pg8::DenseOrder, false, true>(ring, F.X1(), F.WRS(), D, S, E); if (BOTH(6)) GRID_BAR(); }
    if (IN(7)) { route_phase(F); if (BOTH(7)) GRID_BAR(); }
    if (IN(8)) { dispatch_phase(F); if (BOTH(8)) GRID_BAR(); }
    if (IN(9)) { const int n_my = group_preload<2, true>(F, 512);
        pg8::GroupOrder S{(const LAS i32x4*)(F.lds + UT_OFF), (const LAS unsigned short*)(F.lds + ROWS_OFF), n_my}; pg8::EpiUp E{F.HE()};
        pg8::gemm_phase<pg8::EpiUp, pg8::GroupOrder, true, true>(ring, F.X1(), F.EW13(), D, S, E); if (BOTH(9)) GRID_BAR(); }
    if (IN(10)) { const int n_my = group_preload<4, false>(F, 1024);
        pg8::GroupOrder S{(const LAS i32x4*)(F.lds + UT_OFF), (const LAS unsigned short*)(F.lds + ROWS_OFF), n_my}; pg8::EpiDown E{F.YS(), F.SGATE()};
        pg8::gemm_phase<pg8::EpiDown, pg8::GroupOrder, false, true>(ring, F.HE(), F.EW2(), DE, S, E); if (BOTH(10)) GRID_BAR(); }
    if (IN(11)) { pg8::DenseOrder S; S.init(T, D, F.G, F.bx); pg8::EpiSh2 E{F.X1(), F.out()};
        pg8::gemm_phase<pg8::EpiSh2, pg8::DenseOrder, false, true>(ring, F.HS(), F.WS2(), DE, S, E); if (BOTH(11)) GRID_BAR(); }
    if (IN(12)) { combine_phase(F); }
#undef IN
#undef BOTH
#undef GRID_BAR
}

extern "C" void kernel_launch(void* const* d_in, const int* in_sizes, int n_in, void* d_out, int out_size, void* d_ws, size_t ws_size, hipStream_t stream) {
    static int grid = 0;
    if (grid == 0) {
        if (n_in != 24 || out_size != T * D || ws_size < WS_END) { fprintf(stderr, "kernel_launch: unexpected shapes (n_in %d out %d ws %zu)\n", n_in, out_size, ws_size); grid = -1; return; }
        int dev = 0, cus = 0;
        if (hipGetDevice(&dev) != hipSuccess || hipDeviceGetAttribute(&cus, hipDeviceAttributeMultiprocessorCount, dev) != hipSuccess) { grid = -1; return; }
        if (hipFuncSetAttribute((const void*)fwd_kernel, hipFuncAttributeMaxDynamicSharedMemorySize, LDS_BYTES) != hipSuccess) { fprintf(stderr, "kernel_launch: hipFuncSetAttribute failed\n"); grid = -1; return; }
        int per_cu = 0;
        if (hipOccupancyMaxActiveBlocksPerMultiprocessor(&per_cu, (const void*)fwd_kernel, NT, LDS_BYTES) != hipSuccess || per_cu < 1) fprintf(stderr, "kernel_launch: occupancy query says %d\n", per_cu);
        (void)hipGetLastError();
        grid = cus;
        if (grid != 256) fprintf(stderr, "kernel_launch: %d CUs (built for 256)\n", grid);
    }
    if (grid < 0) return;
    (void)hipMemsetAsync((char*)d_ws + WS_CTL, 0, CTL_ZERO_BYTES, stream);
    Args a{};
    for (int i = 0; i < 24; ++i) a.in[i] = (const float*)d_in[i];
    a.out = (float*)d_out; a.ws = (unsigned char*)d_ws; a.pad = 0;
    for (int li = 0; li < N_LAUNCHES; ++li) {
        a.ph_lo = (N_LAUNCHES == 1) ? 0 : li; a.ph_hi = (N_LAUNCHES == 1) ? NPH : li + 1; a.li = li;
        hipLaunchKernelGGL(fwd_kernel, dim3(grid), dim3(NT), LDS_BYTES, stream, a);
    }
}
```
